# Optimizing an MI355X kernel written in HIP

```python
import jax
import jax.numpy as jnp
from jax import lax
import numpy as np

D_MODEL = 1024
BATCH = 2
SEQ = 8192
DEPTH = 1

CHUNK = 64
D_MIX = D_MODEL
D_CONV = D_MIX // 2
D_LRU = D_MIX - D_CONV
CONV_GROUPS = 8
LRU_HEADS = 8
LRU_HEAD_DIM = D_LRU // LRU_HEADS
SHORT_CONV_WIDTH = 3
LRU_CONV_WIDTH = 4
LRU_C = 8.0
IN_COLS = 3 * D_CONV + 2 * D_LRU
N_EXPERTS = 32
TOP_K = 4
D_EXPERT = D_MODEL
SWIGLU_LIMIT = 7.0
SWIGLU_ALPHA = 1.702
EXPERT_BLOCK = 256
LN_EPS = 1e-5
DEEPNORM_ALPHA = (2.0 * DEPTH) ** 0.25
DEEPNORM_BETA = (8.0 * DEPTH) ** -0.25

kernel_name = "hybrid_conv_rglru_moe_deepnorm"


def _layer_norm(x, g, b):
    xf = x.astype(jnp.float32)
    mu = jnp.mean(xf, axis=-1, keepdims=True)
    var = jnp.mean(jnp.square(xf - mu), axis=-1, keepdims=True)
    return ((xf - mu) * lax.rsqrt(var + LN_EPS) * g.astype(jnp.float32) + b.astype(jnp.float32)).astype(x.dtype)


def _causal_depthwise_conv(u, w):
    k = w.shape[0]
    return lax.conv_general_dilated(
        u, w[:, None, :].astype(u.dtype), window_strides=(1,), padding=[(k - 1, 0)],
        dimension_numbers=('NWC', 'WIO', 'NWC'), feature_group_count=u.shape[-1])


def _linear_recurrence_combine(left, right):
    a_l, b_l = left
    a_r, b_r = right
    return a_l * a_r, a_r * b_l + b_r


def _rg_lru(u, w_r, b_r, w_i, b_i, lam):
    bsz, seq, width = u.shape
    uh = u.reshape(bsz, seq, LRU_HEADS, LRU_HEAD_DIM)
    r = jax.nn.sigmoid((jnp.einsum('bshi,hij->bshj', uh, w_r).reshape(bsz, seq, width) + b_r).astype(jnp.float32))
    i = jax.nn.sigmoid((jnp.einsum('bshi,hij->bshj', uh, w_i).reshape(bsz, seq, width) + b_i).astype(jnp.float32))
    log_a = -LRU_C * r * jax.nn.softplus(-lam.astype(jnp.float32))
    a = jnp.exp(log_a)
    b = jnp.sqrt(-jnp.expm1(2.0 * log_a)) * (i * u.astype(jnp.float32))
    _, h = lax.associative_scan(_linear_recurrence_combine, (a, b), axis=1)
    return h.astype(u.dtype)


def _mixer(x, w_in, conv_w, lru_conv_w, lru_conv_b, w_rgate, b_rgate, w_igate, b_igate, lru_lambda, w_out):
    proj = jnp.einsum('bsd,dc->bsc', x, w_in)
    c_b, c_c, c_h, r_x, r_g = jnp.split(
        proj, [D_CONV, 2 * D_CONV, 3 * D_CONV, 3 * D_CONV + D_LRU], axis=-1)
    y_conv = c_b * _causal_depthwise_conv(c_c * c_h, conv_w)
    u = _causal_depthwise_conv(r_x, lru_conv_w) + lru_conv_b
    y_lru = _rg_lru(u, w_rgate, b_rgate, w_igate, b_igate, lru_lambda) * jax.nn.gelu(r_g)
    mix = jnp.concatenate([y_conv, y_lru], axis=-1)
    return jnp.einsum('bsc,cd->bsd', mix, w_out)


def _moe(x, w_router, b_router, w_gu, b_gu, w_dn, b_dn):
    bsz, seq, d = x.shape
    n_tok = bsz * seq
    n_assign = n_tok * TOP_K
    n_blocks = -(-n_assign // EXPERT_BLOCK) + N_EXPERTS
    xt = x.reshape(n_tok, d)
    logits = (xt @ w_router + b_router).astype(jnp.float32)
    top_v, top_e = lax.top_k(logits, TOP_K)
    gates = jax.nn.softmax(top_v, axis=-1).astype(x.dtype)
    flat_e = top_e.reshape(-1)
    order = jnp.argsort(flat_e)
    e_sorted = flat_e[order]
    counts = jnp.bincount(flat_e, length=N_EXPERTS)
    padded = (counts + EXPERT_BLOCK - 1) // EXPERT_BLOCK * EXPERT_BLOCK
    pad_end = jnp.cumsum(padded)
    pad_start = pad_end - padded
    grp_start = jnp.cumsum(counts) - counts
    dest = pad_start[e_sorted] + jnp.arange(n_assign) - grp_start[e_sorted]
    x_pad = jnp.zeros((n_blocks * EXPERT_BLOCK, d), x.dtype).at[dest].set(xt[order // TOP_K])
    block_e = jnp.minimum(
        jnp.searchsorted(pad_end, jnp.arange(n_blocks) * EXPERT_BLOCK, side='right'), N_EXPERTS - 1)

    def expert_block(args):
        xb, e = args
        h = xb @ w_gu[e] + b_gu[e]
        h_glu = jnp.minimum(h[:, :D_EXPERT], SWIGLU_LIMIT)
        h_lin = jnp.clip(h[:, D_EXPERT:], -SWIGLU_LIMIT, SWIGLU_LIMIT)
        act = h_glu * jax.nn.sigmoid(SWIGLU_ALPHA * h_glu) * (h_lin + 1.0)
        return act @ w_dn[e] + b_dn[e]

    y_pad = lax.map(expert_block, (x_pad.reshape(n_blocks, EXPERT_BLOCK, d), block_e))
    y_pad = y_pad.reshape(n_blocks * EXPERT_BLOCK, d)
    slot = jnp.zeros((n_assign,), dest.dtype).at[order].set(dest)
    y = y_pad[slot].reshape(n_tok, TOP_K, d)
    return jnp.einsum('tkd,tk->td', y, gates).reshape(bsz, seq, d)


def setup_inputs(seed: int = 0) -> dict:
    key = jax.random.key(seed)
    ks = jax.random.split(key, 22)
    f32 = jnp.float32
    nrm = lambda k, shape, s: jax.random.normal(k, shape, f32) * s
    u = jax.random.uniform(ks[11], (DEPTH, D_LRU), f32, minval=0.9, maxval=0.999)
    s = u ** (1.0 / LRU_C)
    lru_lambda = jnp.log(s) - jnp.log1p(-s)
    return {
        "x": nrm(ks[0], (BATCH, SEQ, D_MODEL), 1.0),
        "w_in": nrm(ks[1], (DEPTH, D_MODEL, IN_COLS), D_MODEL ** -0.5),
        "conv_w": nrm(ks[2], (DEPTH, SHORT_CONV_WIDTH, D_CONV), SHORT_CONV_WIDTH ** -0.5),
        "lru_conv_w": nrm(ks[3], (DEPTH, LRU_CONV_WIDTH, D_LRU), LRU_CONV_WIDTH ** -0.5),
        "lru_conv_b": nrm(ks[4], (DEPTH, D_LRU), 0.01),
        "w_rgate": nrm(ks[5], (DEPTH, LRU_HEADS, LRU_HEAD_DIM, LRU_HEAD_DIM), LRU_HEAD_DIM ** -0.5),
        "b_rgate": nrm(ks[6], (DEPTH, D_LRU), 0.01),
        "w_igate": nrm(ks[7], (DEPTH, LRU_HEADS, LRU_HEAD_DIM, LRU_HEAD_DIM), LRU_HEAD_DIM ** -0.5),
        "b_igate": nrm(ks[8], (DEPTH, D_LRU), 0.01),
        "lru_lambda": lru_lambda,
        "w_out": nrm(ks[9], (DEPTH, D_MIX, D_MODEL), D_MIX ** -0.5 * DEEPNORM_BETA),
        "ln1_g": 1.0 + nrm(ks[10], (DEPTH, D_MODEL), 0.02),
        "ln1_b": nrm(ks[12], (DEPTH, D_MODEL), 0.02),
        "w_router": nrm(ks[13], (DEPTH, D_MODEL, N_EXPERTS), D_MODEL ** -0.5),
        "b_router": nrm(ks[14], (DEPTH, N_EXPERTS), 0.01),
        "w_gate_up": nrm(ks[15], (DEPTH, N_EXPERTS, D_MODEL, 2 * D_EXPERT), D_MODEL ** -0.5),
        "b_gate_up": nrm(ks[16], (DEPTH, N_EXPERTS, 2 * D_EXPERT), 0.01),
        "w_down": nrm(ks[17], (DEPTH, N_EXPERTS, D_EXPERT, D_MODEL), D_EXPERT ** -0.5 * DEEPNORM_BETA),
        "b_down": nrm(ks[18], (DEPTH, N_EXPERTS, D_MODEL), 0.01),
        "ln2_g": 1.0 + nrm(ks[19], (DEPTH, D_MODEL), 0.02),
        "ln2_b": nrm(ks[20], (DEPTH, D_MODEL), 0.02),
    }


def reference(x, w_in, conv_w, lru_conv_w, lru_conv_b, w_rgate, b_rgate, w_igate, b_igate, lru_lambda,
              w_out, ln1_g, ln1_b, w_router, b_router, w_gate_up, b_gate_up, w_down, b_down, ln2_g, ln2_b):
    for l in range(DEPTH):
        mixed = _mixer(x, w_in[l], conv_w[l], lru_conv_w[l], lru_conv_b[l], w_rgate[l], b_rgate[l],
                       w_igate[l], b_igate[l], lru_lambda[l], w_out[l])
        x = _layer_norm(DEEPNORM_ALPHA * x + mixed, ln1_g[l], ln1_b[l])
        ffn = _moe(x, w_router[l], b_router[l], w_gate_up[l], b_gate_up[l], w_down[l], b_down[l])
        x = _layer_norm(DEEPNORM_ALPHA * x + ffn, ln2_g[l], ln2_b[l])
    return x
```

```cpp
#include <hip/hip_runtime.h>
#include <cstdio>
#include <cstdint>

constexpr int BATCH = 2, SEQ = 8192, D = 1024, M = BATCH * SEQ;
constexpr int DC = 512, DL = 512, NH = 8, HD = 64, INC = 2560;
constexpr int NE = 32, TOPK = 4, DE = 1024;
constexpr float ALPHA = 1.189207115002721f;
constexpr float LN_EPS = 1e-5f;
constexpr int NSLOT = 65536 + NE * 256;
constexpr int NTILE = NSLOT / 256;
constexpr int CH = 64;
constexpr int NCH = SEQ / CH;

typedef float f32x4 __attribute__((ext_vector_type(4)));

__device__ __forceinline__ float wave_sum(float v) {
#pragma unroll
    for (int o = 1; o < 64; o <<= 1) v += __shfl_xor(v, o);
    return v;
}
__device__ __forceinline__ float sigmoidf_(float x) { return 1.f / (1.f + __expf(-x)); }
__device__ __forceinline__ float gelu_tanh(float x) {
    const float u = 0.7978845608028654f * (x + 0.044715f * x * x * x);
    const float t = 1.f - 2.f / (1.f + __expf(2.f * u));
    return 0.5f * x * (1.f + t);
}

template <int MODE>
__global__ void __launch_bounds__(256) gemm_naive(const float* __restrict__ A, const float* __restrict__ B, float* __restrict__ C, int N, int K, int lda, int ldb, int ldc,
                                                  const int* __restrict__ rowidx, const int* __restrict__ tile_e, const int* __restrict__ ntiles_ptr,
                                                  size_t b_stride, const float* __restrict__ bias, int bias_stride) {
    __shared__ float As[16][68];
    __shared__ float Bs[16][64];
    __shared__ float Bs2[MODE == 1 ? 16 : 1][64];
    const int bm = blockIdx.y, bn = blockIdx.x, tid = threadIdx.x, tx = tid & 15, ty = tid >> 4;
    if (MODE != 0) {
        const int t256 = bm >> 2;
        if (t256 >= *ntiles_ptr) return;
        const int e = tile_e[t256];
        B += (size_t)e * b_stride; bias += (size_t)e * bias_stride;
    }
    const int ar = tid >> 2, ak = (tid & 3) * 4;
    const int grow = bm * 64 + ar;
    const float* arow = A + (size_t)((MODE == 1) ? rowidx[grow] : grow) * lda;
    const int bk = tid >> 4, bn4 = (tid & 15) * 4;
    float acc[4][4] = {}, acc2[4][4] = {};
    for (int k0 = 0; k0 < K; k0 += 16) {
        const f32x4 av = *(const f32x4*)(arow + k0 + ak);
        As[ak + 0][ar] = av[0]; As[ak + 1][ar] = av[1]; As[ak + 2][ar] = av[2]; As[ak + 3][ar] = av[3];
        *(f32x4*)&Bs[bk][bn4] = *(const f32x4*)(B + (size_t)(k0 + bk) * ldb + bn * 64 + bn4);
        if (MODE == 1) *(f32x4*)&Bs2[bk][bn4] = *(const f32x4*)(B + (size_t)(k0 + bk) * ldb + 1024 + bn * 64 + bn4);
        __syncthreads();
#pragma unroll
        for (int k = 0; k < 16; ++k) {
            const f32x4 a = *(const f32x4*)&As[k][ty * 4];
            const f32x4 b = *(const f32x4*)&Bs[k][tx * 4];
#pragma unroll
            for (int i = 0; i < 4; ++i)
#pragma unroll
                for (int j = 0; j < 4; ++j) acc[i][j] += a[i] * b[j];
            if (MODE == 1) {
                const f32x4 b2 = *(const f32x4*)&Bs2[k][tx * 4];
#pragma unroll
                for (int i = 0; i < 4; ++i)
#pragma unroll
                    for (int j = 0; j < 4; ++j) acc2[i][j] += a[i] * b2[j];
            }
        }
        __syncthreads();
    }
#pragma unroll
    for (int i = 0; i < 4; ++i) {
        const int r = bm * 64 + ty * 4 + i, c = bn * 64 + tx * 4;
        f32x4 o;
#pragma unroll
        for (int j = 0; j < 4; ++j) {
            float v = acc[i][j];
            if (MODE == 1) {
                float g = v + bias[c + j], l = acc2[i][j] + bias[1024 + c + j];
                g = fminf(g, 7.f); l = fminf(fmaxf(l, -7.f), 7.f);
                v = g * sigmoidf_(1.702f * g) * (l + 1.f);
            } else if (MODE == 2) v += bias[c + j];
            o[j] = v;
        }
        *(f32x4*)(C + (size_t)r * ldc + c) = o;
    }
}

__global__ void mixer_conv_kernel(const float* __restrict__ proj, const float* __restrict__ conv_w, float* __restrict__ mix) {
    const int total = M * (DC / 4);
    for (int it = blockIdx.x * blockDim.x + threadIdx.x; it < total; it += gridDim.x * blockDim.x) {
        const int row = it / (DC / 4), c = (it % (DC / 4)) * 4, t = row % SEQ;
        f32x4 s = {0.f, 0.f, 0.f, 0.f};
#pragma unroll
        for (int k = 0; k < 3; ++k) {
            const int tt = t - 2 + k;
            if (tt >= 0) {
                const float* p = proj + (size_t)(row - 2 + k) * INC;
                const f32x4 cc = *(const f32x4*)(p + DC + c), ch = *(const f32x4*)(p + 2 * DC + c), w = *(const f32x4*)(conv_w + k * DC + c);
                s += w * (cc * ch);
            }
        }
        const f32x4 cb = *(const f32x4*)(proj + (size_t)row * INC + c);
        *(f32x4*)(mix + (size_t)row * D + c) = cb * s;
    }
}

template <int PASS>
__global__ void __launch_bounds__(256) lru_kernel(const float* __restrict__ proj, const float* __restrict__ cw, const float* __restrict__ cb,
                                                  const float* __restrict__ w_r, const float* __restrict__ b_r, const float* __restrict__ w_i, const float* __restrict__ b_i,
                                                  const float* __restrict__ lam, float* __restrict__ summ  , float* __restrict__ mix) {
    __shared__ float u_s[4][CH][HD];
    const int wid = threadIdx.x >> 6, lane = threadIdx.x & 63;
    const int nitems = BATCH * NCH * NH;
    for (int item = blockIdx.x * 4 + wid; item < nitems; item += gridDim.x * 4) {
        const int h = item % NH, c = (item / NH) % NCH, b = item / (NH * NCH);
        const int cj = h * HD + lane;
        const size_t row0 = (size_t)b * SEQ + (size_t)c * CH;
        const float* px = proj + 3 * DC + cj;
        const float w0 = cw[0 * DL + cj], w1 = cw[1 * DL + cj], w2 = cw[2 * DL + cj], w3 = cw[3 * DL + cj], bb = cb[cj];
        float x0 = 0.f, x1 = 0.f, x2 = 0.f;
        if (c > 0) { x0 = px[(row0 - 3) * INC]; x1 = px[(row0 - 2) * INC]; x2 = px[(row0 - 1) * INC]; }
        for (int t = 0; t < CH; ++t) {
            const float x3 = px[(row0 + t) * INC];
            u_s[wid][t][lane] = w0 * x0 + w1 * x1 + w2 * x2 + w3 * x3 + bb;
            x0 = x1; x1 = x2; x2 = x3;
        }
        __builtin_amdgcn_s_waitcnt(0xc07f);
        float wr[HD], wi[HD];
#pragma unroll
        for (int i = 0; i < HD; ++i) { wr[i] = w_r[(size_t)h * HD * HD + i * HD + lane]; wi[i] = w_i[(size_t)h * HD * HD + i * HD + lane]; }
        const float br = b_r[cj], bi = b_i[cj];
        const float l = lam[cj];
        const float sp = (l > 0.f) ? log1pf(__expf(-l)) : (-l + log1pf(__expf(l)));
        float hst = 0.f, aprod = 1.f;
        if (PASS == 2) {
            const float* sb = summ + (size_t)b * NCH * 2 * DL;
            for (int cc = 0; cc < c; ++cc) { const float a = sb[(size_t)cc * 2 * DL + cj], he = sb[(size_t)cc * 2 * DL + DL + cj]; hst = a * hst + he; }
        }
        for (int t = 0; t < CH; ++t) {
            float pr = br, pi = bi;
#pragma unroll
            for (int i4 = 0; i4 < HD; i4 += 4) {
                const f32x4 uv = *(const f32x4*)&u_s[wid][t][i4];
#pragma unroll
                for (int q = 0; q < 4; ++q) { pr += uv[q] * wr[i4 + q]; pi += uv[q] * wi[i4 + q]; }
            }
            const float r = sigmoidf_(pr), ig = sigmoidf_(pi);
            const float loga = -8.f * r * sp;
            const float a = __expf(loga);
            const float bt = sqrtf(fmaxf(-expm1f(2.f * loga), 0.f)) * (ig * u_s[wid][t][lane]);
            hst = a * hst + bt; aprod *= a;
            if (PASS == 2) {
                const float rg = proj[(row0 + t) * INC + 4 * DC + cj];
                mix[(row0 + t) * D + DC + cj] = hst * gelu_tanh(rg);
            }
        }
        if (PASS == 1) { float* sb = summ + ((size_t)b * NCH + c) * 2 * DL; sb[cj] = aprod; sb[DL + cj] = hst; }
        __builtin_amdgcn_s_waitcnt(0xc07f);
    }
}

__global__ void ln1_kernel(const float* __restrict__ x, const float* __restrict__ y, const float* __restrict__ g, const float* __restrict__ bta, float* __restrict__ out) {
    const int lane = threadIdx.x & 63, gw = (blockIdx.x * blockDim.x + threadIdx.x) >> 6, ngw = (gridDim.x * blockDim.x) >> 6;
    for (int row = gw; row < M; row += ngw) {
        f32x4 v[4]; float s = 0.f;
#pragma unroll
        for (int j = 0; j < 4; ++j) { const size_t o = (size_t)row * D + j * 256 + lane * 4; v[j] = ALPHA * *(const f32x4*)(x + o) + *(const f32x4*)(y + o); s += (v[j][0] + v[j][1]) + (v[j][2] + v[j][3]); }
        const float mean = wave_sum(s) * (1.f / D); float q = 0.f;
#pragma unroll
        for (int j = 0; j < 4; ++j) { v[j] = v[j] - mean; q += (v[j][0] * v[j][0] + v[j][1] * v[j][1]) + (v[j][2] * v[j][2] + v[j][3] * v[j][3]); }
        const float rstd = rsqrtf(wave_sum(q) * (1.f / D) + LN_EPS);
#pragma unroll
        for (int j = 0; j < 4; ++j) { const int cidx = j * 256 + lane * 4; *(f32x4*)(out + (size_t)row * D + cidx) = v[j] * rstd * *(const f32x4*)(g + cidx) + *(const f32x4*)(bta + cidx); }
    }
}

__global__ void router_kernel(const float* __restrict__ x1, const float* __restrict__ wr, const float* __restrict__ br, int* __restrict__ top_e, float* __restrict__ top_g) {
    const int lane = threadIdx.x & 63, gw = (blockIdx.x * blockDim.x + threadIdx.x) >> 6, ngw = (gridDim.x * blockDim.x) >> 6;
    for (int row = gw; row < M; row += ngw) {
        float lg[NE];
#pragma unroll
        for (int e = 0; e < NE; ++e) lg[e] = 0.f;
        for (int j = 0; j < 16; ++j) {
            const int c = j * 64 + lane;
            const float xv = x1[(size_t)row * D + c];
            const float* w = wr + (size_t)c * NE;
#pragma unroll
            for (int e4 = 0; e4 < NE; e4 += 4) { const f32x4 wv = *(const f32x4*)(w + e4); lg[e4] += xv * wv[0]; lg[e4 + 1] += xv * wv[1]; lg[e4 + 2] += xv * wv[2]; lg[e4 + 3] += xv * wv[3]; }
        }
#pragma unroll
        for (int e = 0; e < NE; ++e) lg[e] = wave_sum(lg[e]) + br[e];
        int se[TOPK]; float sv[TOPK];
#pragma unroll
        for (int k = 0; k < TOPK; ++k) {
            float best = -INFINITY; int bi = 0;
#pragma unroll
            for (int e = 0; e < NE; ++e) { const bool taken = (k > 0 && se[0] == e) || (k > 1 && se[1] == e) || (k > 2 && se[2] == e); if (!taken && lg[e] > best) { best = lg[e]; bi = e; } }
            se[k] = bi; sv[k] = best;
        }
        const float m0 = sv[0];
        float ex[TOPK], sum = 0.f;
#pragma unroll
        for (int k = 0; k < TOPK; ++k) { ex[k] = __expf(sv[k] - m0); sum += ex[k]; }
        if (lane < TOPK) { int e = se[0]; float gq = ex[0]; if (lane == 1) { e = se[1]; gq = ex[1]; } if (lane == 2) { e = se[2]; gq = ex[2]; } if (lane == 3) { e = se[3]; gq = ex[3]; }
            top_e[row * TOPK + lane] = e; top_g[row * TOPK + lane] = gq / sum; }
    }
}

__global__ void __launch_bounds__(1024) place_kernel(const int* __restrict__ top_e, int* __restrict__ tab, int* __restrict__ tok_of_slot, int* __restrict__ slot_of) {
    __shared__ int cnt[NE], pst[NE], cur[NE];
    const int tid = threadIdx.x;
    if (tid < NE) { cnt[tid] = 0; cur[tid] = 0; }
    __syncthreads();
    for (int i = tid; i < M * TOPK; i += 1024) atomicAdd(&cnt[top_e[i]], 1);
    for (int i = tid; i < NSLOT; i += 1024) tok_of_slot[i] = 0;
    __syncthreads();
    if (tid == 0) {
        int s = 0;
        for (int e = 0; e < NE; ++e) { pst[e] = s; tab[e] = cnt[e]; tab[32 + e] = s; const int nt = (cnt[e] + 255) / 256; for (int t = 0; t < nt; ++t) tab[128 + s / 256 + t] = e; s += nt * 256; }
        tab[64] = s / 256;
    }
    __syncthreads();
    for (int i = tid; i < M * TOPK; i += 1024) { const int e = top_e[i]; const int r = atomicAdd(&cur[e], 1); const int slot = pst[e] + r; tok_of_slot[slot] = i / TOPK; slot_of[i] = slot; }
}

__global__ void combine_ln2_kernel(const float* __restrict__ x1, const float* __restrict__ ypad, const int* __restrict__ slot_of, const float* __restrict__ top_g,
                                   const float* __restrict__ g, const float* __restrict__ bta, float* __restrict__ out) {
    const int lane = threadIdx.x & 63, gw = (blockIdx.x * blockDim.x + threadIdx.x) >> 6, ngw = (gridDim.x * blockDim.x) >> 6;
    for (int row = gw; row < M; row += ngw) {
        int sl[TOPK]; float gg[TOPK];
#pragma unroll
        for (int k = 0; k < TOPK; ++k) { sl[k] = slot_of[row * TOPK + k]; gg[k] = top_g[row * TOPK + k]; }
        f32x4 v[4]; float s = 0.f;
#pragma unroll
        for (int j = 0; j < 4; ++j) {
            const int cidx = j * 256 + lane * 4;
            f32x4 a = ALPHA * *(const f32x4*)(x1 + (size_t)row * D + cidx);
            f32x4 f = {0.f, 0.f, 0.f, 0.f};
#pragma unroll
            for (int k = 0; k < TOPK; ++k) f += gg[k] * *(const f32x4*)(ypad + (size_t)sl[k] * D + cidx);
            v[j] = a + f; s += (v[j][0] + v[j][1]) + (v[j][2] + v[j][3]);
        }
        const float mean = wave_sum(s) * (1.f / D); float q = 0.f;
#pragma unroll
        for (int j = 0; j < 4; ++j) { v[j] = v[j] - mean; q += (v[j][0] * v[j][0] + v[j][1] * v[j][1]) + (v[j][2] * v[j][2] + v[j][3] * v[j][3]); }
        const float rstd = rsqrtf(wave_sum(q) * (1.f / D) + LN_EPS);
#pragma unroll
        for (int j = 0; j < 4; ++j) { const int cidx = j * 256 + lane * 4; *(f32x4*)(out + (size_t)row * D + cidx) = v[j] * rstd * *(const f32x4*)(g + cidx) + *(const f32x4*)(bta + cidx); }
    }
}

extern "C" void kernel_launch(void* const* d_in, const int* in_sizes, int n_in, void* d_out, int out_size, void* d_ws, size_t ws_size, hipStream_t stream) {
    const float* x = (const float*)d_in[0];        const float* w_in = (const float*)d_in[1];     const float* conv_w = (const float*)d_in[2];
    const float* lru_cw = (const float*)d_in[3];   const float* lru_cb = (const float*)d_in[4];   const float* w_rg = (const float*)d_in[5];
    const float* b_rg = (const float*)d_in[6];     const float* w_ig = (const float*)d_in[7];     const float* b_ig = (const float*)d_in[8];
    const float* lam = (const float*)d_in[9];      const float* w_out = (const float*)d_in[10];   const float* ln1_g = (const float*)d_in[11];
    const float* ln1_b = (const float*)d_in[12];   const float* w_router = (const float*)d_in[13]; const float* b_router = (const float*)d_in[14];
    const float* w_gu = (const float*)d_in[15];    const float* b_gu = (const float*)d_in[16];    const float* w_dn = (const float*)d_in[17];
    const float* b_dn = (const float*)d_in[18];    const float* ln2_g = (const float*)d_in[19];   const float* ln2_b = (const float*)d_in[20];
    float* out = (float*)d_out;
    char* ws = (char*)d_ws;
    const size_t MiB = 1u << 20;
    int* tab = (int*)(ws + 0);
    int* top_e = (int*)(ws + 1 * MiB);
    float* top_g = (float*)(ws + 2 * MiB);
    int* slot_of = (int*)(ws + 3 * MiB);
    int* tok_of_slot = (int*)(ws + 4 * MiB);
    float* summ = (float*)(ws + 5 * MiB);
    float* x1 = (float*)(ws + 8 * MiB);
    float* proj = (float*)(ws + 72 * MiB);
    float* mix = (float*)(ws + 232 * MiB);
    float* mixed = (float*)(ws + 296 * MiB);
    float* act = (float*)(ws + 72 * MiB);
    float* ypad = (float*)(ws + 360 * MiB);
    if (ws_size < 648 * MiB) { fprintf(stderr, "ws too small\n"); return; }

    gemm_naive<0><<<dim3(INC / 64, M / 64), 256, 0, stream>>>(x, w_in, proj, INC, D, D, INC, INC, nullptr, nullptr, nullptr, 0, nullptr, 0);
    mixer_conv_kernel<<<2048, 256, 0, stream>>>(proj, conv_w, mix);
    lru_kernel<1><<<512, 256, 0, stream>>>(proj, lru_cw, lru_cb, w_rg, b_rg, w_ig, b_ig, lam, summ, mix);
    lru_kernel<2><<<512, 256, 0, stream>>>(proj, lru_cw, lru_cb, w_rg, b_rg, w_ig, b_ig, lam, summ, mix);
    gemm_naive<0><<<dim3(D / 64, M / 64), 256, 0, stream>>>(mix, w_out, mixed, D, D, D, D, D, nullptr, nullptr, nullptr, 0, nullptr, 0);
    ln1_kernel<<<1024, 256, 0, stream>>>(x, mixed, ln1_g, ln1_b, x1);
    router_kernel<<<1024, 256, 0, stream>>>(x1, w_router, b_router, top_e, top_g);
    place_kernel<<<1, 1024, 0, stream>>>(top_e, tab, tok_of_slot, slot_of);
    gemm_naive<1><<<dim3(DE / 64, NSLOT / 64), 256, 0, stream>>>(x1, w_gu, act, DE, D, D, 2 * DE, DE, tok_of_slot, tab + 128, tab + 64, (size_t)D * 2 * DE, b_gu, 2 * DE);
    gemm_naive<2><<<dim3(D / 64, NSLOT / 64), 256, 0, stream>>>(act, w_dn, ypad, D, DE, DE, D, D, nullptr, tab + 128, tab + 64, (size_t)DE * D, b_dn, D);
    combine_ln2_kernel<<<1024, 256, 0, stream>>>(x1, ypad, slot_of, top_g, ln2_g, ln2_b, out);
}
```
